# Optimizing an MI355X kernel written in HIP

```python
import jax, jax.numpy as jnp
from jax import lax
import numpy as np

D_MODEL = 1024
BATCH = 8
SEQ = 2048
DEPTH = 2
DEC_BATCH = 128
DEC_SEQ = 4
PAST_LEN = 16384
PAGE_SIZE = 128

N_EVEN = (DEPTH + 1) // 2
N_ODD = DEPTH // 2
MIX_A = D_MODEL // 2
HEAD_A = 64
N_HEADS_A = MIX_A // HEAD_A
LORA_DECAY = 64
LORA_ICLR = 64
LORA_GATE = 128
PROJ_A = 3 * MIX_A + LORA_DECAY + LORA_ICLR + LORA_GATE
MIX_B = D_MODEL - MIX_A
PROJ_B = 3 * MIX_B
CONV_W = 3
CHUNK = 128
GM_WIDTH = D_MODEL
GM_GROUPS = 8
GM_GROUP_DIM = GM_WIDTH // GM_GROUPS
N_MEM = 256
XA_HEADS = 4
XA_HEAD_DIM = D_MODEL // XA_HEADS
D_FF = 2816
RMS_EPS = 1e-6
LN_EPS = 1e-5
GN_EPS = HEAD_A * 1e-5

kernel_name = 'rwkv7_shortconv_chunkgmlp_macaron_decoder_step'


def _rmsnorm(x, g):
    xf = x.astype(jnp.float32)
    y = xf * lax.rsqrt(jnp.mean(xf * xf, axis=-1, keepdims=True) + RMS_EPS)
    return (y * g.astype(jnp.float32)).astype(x.dtype)


def _layernorm(x, g, b, eps):
    xf = x.astype(jnp.float32)
    mu = jnp.mean(xf, axis=-1, keepdims=True)
    var = jnp.mean(jnp.square(xf - mu), axis=-1, keepdims=True)
    y = (xf - mu) * lax.rsqrt(var + eps) * g.astype(jnp.float32) + b.astype(jnp.float32)
    return y.astype(x.dtype)


def _swiglu(x, wg, wu, wd):
    return (jax.nn.silu(x @ wg) * (x @ wu)) @ wd


def _wkv7(r, w, k, v, a, b, s0):
    def step(s, inp):
        rt, wt, kt, vt, at, bt = inp
        sa = jnp.einsum('bhij,bhj->bhi', s, at)
        s = s * wt[:, :, None, :] + sa[..., None] * bt[:, :, None, :] + vt[..., None] * kt[:, :, None, :]
        return s, jnp.einsum('bhij,bhj->bhi', s, rt)
    xs = tuple(jnp.moveaxis(t.astype(jnp.float32), 1, 0) for t in (r, w, k, v, a, b))
    s, ys = lax.scan(step, s0.astype(jnp.float32), xs)
    return jnp.moveaxis(ys, 0, 1), s


def _rwkv7(p, prev, s0, mu, w0, w2, a0, a2, g2, k_k, k_a, r_k, lnx_w, lnx_b):
    bn, t, _ = p.shape
    p_prev = jnp.concatenate([prev[:, None].astype(p.dtype), p[:, :-1]], axis=1)
    ps = p + mu * (p_prev - p)
    o1, o2, o3 = MIX_A, 2 * MIX_A, 3 * MIX_A
    o4 = o3 + LORA_DECAY
    o5 = o4 + LORA_ICLR
    r, k, v = ps[..., :o1], ps[..., o1:o2], ps[..., o2:o3]
    wd, ad, gd = ps[..., o3:o4], ps[..., o4:o5], ps[..., o5:]
    w = -jax.nn.softplus(-(w0 + jnp.tanh(wd) @ w2)) - 0.5
    decay = jnp.exp(-jnp.exp(w.astype(jnp.float32)))
    a = jax.nn.sigmoid(a0 + ad @ a2)
    g = jax.nn.sigmoid(gd) @ g2
    hs = lambda z: z.reshape(bn, t, N_HEADS_A, HEAD_A)
    kk = hs(k * k_k).astype(jnp.float32)
    kk = kk / jnp.maximum(jnp.sqrt(jnp.sum(kk * kk, axis=-1, keepdims=True)), 1e-12)
    k = k * (1.0 + (a - 1.0) * k_a)
    rh, kh, vh, ah = hs(r), hs(k), hs(v), hs(a)
    y, s = _wkv7(rh, hs(decay), kh, vh, -kk, kk * ah, s0)
    y = _layernorm(y.astype(rh.dtype), lnx_w.reshape(N_HEADS_A, HEAD_A), lnx_b.reshape(N_HEADS_A, HEAD_A), GN_EPS)
    y = y + jnp.sum(rh * kh * r_k, axis=-1, keepdims=True) * vh
    out = y.reshape(bn, t, MIX_A) * g
    return out, p[:, -1], s


def _short_conv(p, buf, conv_w):
    h, bg, cg = p[..., :MIX_B], p[..., MIX_B:2 * MIX_B], p[..., 2 * MIX_B:]
    z = cg * h
    zp = jnp.concatenate([buf.astype(z.dtype), z], axis=1)
    t = z.shape[1]
    y = conv_w[0] * zp[:, 0:t]
    for j in range(1, CONV_W):
        y = y + conv_w[j] * zp[:, j:j + t]
    return bg * y, zp[:, -(CONV_W - 1):]


def _chunk_gmlp(p, ln_w, ln_b, w_s, b_s):
    zg = jax.nn.gelu(p, approximate=False)
    u, v = zg[..., :GM_WIDTH], zg[..., GM_WIDTH:]
    v = _layernorm(v, ln_w, ln_b, LN_EPS)
    bn, t, _ = v.shape
    n_chunks = -(-t // CHUNK)
    pad = n_chunks * CHUNK - t
    vc = jnp.pad(v, ((0, 0), (0, pad), (0, 0))).reshape(bn, n_chunks, CHUNK, GM_GROUPS, GM_GROUP_DIM)
    causal = jnp.tril(jnp.ones((CHUNK, CHUNK), dtype=bool))
    ws = jnp.where(causal[None], w_s, jnp.zeros((), w_s.dtype))
    f = jnp.einsum('gts,bnsgc->bntgc', ws, vc) + jnp.transpose(b_s)[None, None, :, :, None]
    f = f.reshape(bn, n_chunks * CHUNK, GM_WIDTH)[:, :t]
    return u * f, v


def _mem_attn(x, mk, mv, wq, wo):
    bn, t, _ = x.shape
    q = (x @ wq).reshape(bn, t, XA_HEADS, XA_HEAD_DIM)
    sc = jnp.einsum('bthd,bmhd->bhtm', q, mk.astype(q.dtype)).astype(jnp.float32) * (XA_HEAD_DIM ** -0.5)
    pr = jax.nn.softmax(sc, axis=-1).astype(x.dtype)
    o = jnp.einsum('bhtm,bmhd->bthd', pr, mv.astype(x.dtype)).reshape(bn, t, D_MODEL)
    return o @ wo


def _trunk(x, mem_k, mem_v, shift0, wkv0, conv0, P):
    shifts, wkvs, convs, vrows = [], [], [], []
    for l in range(DEPTH):
        n = P['norms'][l]
        x = x + 0.5 * _swiglu(_rmsnorm(x, n[0]), P['f1_wg'][l], P['f1_wu'][l], P['f1_wd'][l])
        h = _rmsnorm(x, n[1])
        if l % 2 == 0:
            e = l // 2
            p = h @ P['w_in_even'][e]
            ya, sh, s = _rwkv7(p[..., :PROJ_A], shift0[e], wkv0[e], P['shift_mu'][e],
                               P['decay_w0'][e], P['decay_w2'][e], P['iclr_a0'][e], P['iclr_a2'][e],
                               P['gate_g2'][e], P['k_k'][e], P['k_a'][e], P['r_k'][e],
                               P['lnx_w'][e], P['lnx_b'][e])
            yb, cb = _short_conv(p[..., PROJ_A:], conv0[e], P['conv_w'][e])
            x = x + jnp.concatenate([ya.astype(x.dtype), yb.astype(x.dtype)], axis=-1) @ P['w_out_even'][e]
            shifts.append(sh)
            wkvs.append(s)
            convs.append(cb)
        else:
            o = l // 2
            p = h @ P['w_in_odd'][o]
            yc, vr = _chunk_gmlp(p, P['gm_ln_w'][o], P['gm_ln_b'][o], P['gm_ws'][o], P['gm_bs'][o])
            x = x + yc @ P['w_out_odd'][o]
            vrows.append(vr)
        x = x + _mem_attn(_rmsnorm(x, n[2]), mem_k[l], mem_v[l], P['xa_wq'][l], P['xa_wo'][l])
        x = x + 0.5 * _swiglu(_rmsnorm(x, n[3]), P['f2_wg'][l], P['f2_wu'][l], P['f2_wd'][l])
    return _rmsnorm(x, P['final_norm']), shifts, wkvs, convs, vrows


def setup_inputs(seed: int = 0) -> dict:
    key = jax.random.key(seed)
    ks = iter(jax.random.split(key, 48))
    def nrm(shape, scale=1.0, offset=0.0):
        return offset + scale * jax.random.normal(next(ks), shape, jnp.float32)
    D = D_MODEL
    inp = {}
    inp['x_prompt'] = nrm((BATCH, SEQ, D))
    inp['x_sample'] = nrm((DEC_BATCH, DEC_SEQ, D))
    inp['mem_prompt'] = nrm((BATCH, N_MEM, D))
    inp['state_shift'] = nrm((N_EVEN, DEC_BATCH, PROJ_A))
    inp['state_wkv'] = nrm((N_EVEN, DEC_BATCH, N_HEADS_A, HEAD_A, HEAD_A), 0.5)
    inp['state_conv'] = nrm((N_EVEN, DEC_BATCH, CONV_W - 1, MIX_B))
    inp['cache_mem_k'] = nrm((DEPTH, DEC_BATCH, N_MEM, XA_HEADS, XA_HEAD_DIM))
    inp['cache_mem_v'] = nrm((DEPTH, DEC_BATCH, N_MEM, XA_HEADS, XA_HEAD_DIM))
    inp['norms'] = nrm((DEPTH, 4, D), 0.01, 1.0)
    inp['final_norm'] = nrm((D,), 0.01, 1.0)
    inp['f1_wg'] = nrm((DEPTH, D, D_FF), D ** -0.5)
    inp['f1_wu'] = nrm((DEPTH, D, D_FF), D ** -0.5)
    inp['f1_wd'] = nrm((DEPTH, D_FF, D), D_FF ** -0.5)
    inp['f2_wg'] = nrm((DEPTH, D, D_FF), D ** -0.5)
    inp['f2_wu'] = nrm((DEPTH, D, D_FF), D ** -0.5)
    inp['f2_wd'] = nrm((DEPTH, D_FF, D), D_FF ** -0.5)
    inp['xa_wq'] = nrm((DEPTH, D, D), D ** -0.5)
    inp['xa_wk'] = nrm((DEPTH, D, D), D ** -0.5)
    inp['xa_wv'] = nrm((DEPTH, D, D), D ** -0.5)
    inp['xa_wo'] = nrm((DEPTH, D, D), D ** -0.5)
    inp['w_in_even'] = nrm((N_EVEN, D, PROJ_A + PROJ_B), D ** -0.5)
    inp['w_out_even'] = nrm((N_EVEN, D, D), D ** -0.5)
    inp['shift_mu'] = jax.random.uniform(next(ks), (N_EVEN, PROJ_A), jnp.float32)
    inp['decay_w0'] = nrm((N_EVEN, MIX_A), 0.5, -2.0)
    inp['decay_w2'] = nrm((N_EVEN, LORA_DECAY, MIX_A), 0.5 * LORA_DECAY ** -0.5)
    inp['iclr_a0'] = nrm((N_EVEN, MIX_A), 0.1)
    inp['iclr_a2'] = nrm((N_EVEN, LORA_ICLR, MIX_A), LORA_ICLR ** -0.5)
    inp['gate_g2'] = nrm((N_EVEN, LORA_GATE, MIX_A), LORA_GATE ** -0.5)
    inp['k_k'] = nrm((N_EVEN, MIX_A), 0.05, 0.85)
    inp['k_a'] = nrm((N_EVEN, MIX_A), 0.05, 1.0)
    inp['r_k'] = nrm((N_EVEN, N_HEADS_A, HEAD_A), 0.1)
    inp['lnx_w'] = nrm((N_EVEN, MIX_A), 0.01, 1.0)
    inp['lnx_b'] = nrm((N_EVEN, MIX_A), 0.01)
    inp['conv_w'] = nrm((N_EVEN, CONV_W, MIX_B), CONV_W ** -0.5)
    inp['w_in_odd'] = nrm((N_ODD, D, 2 * GM_WIDTH), D ** -0.5)
    inp['w_out_odd'] = nrm((N_ODD, GM_WIDTH, D), GM_WIDTH ** -0.5)
    inp['gm_ln_w'] = nrm((N_ODD, GM_WIDTH), 0.01, 1.0)
    inp['gm_ln_b'] = nrm((N_ODD, GM_WIDTH), 0.01)
    inp['gm_ws'] = nrm((N_ODD, GM_GROUPS, CHUNK, CHUNK), CHUNK ** -0.5)
    inp['gm_bs'] = nrm((N_ODD, GM_GROUPS, CHUNK), 0.1)
    return inp


def reference(x_prompt, x_sample, mem_prompt, state_shift, state_wkv, state_conv, cache_mem_k, cache_mem_v,
              norms, final_norm, f1_wg, f1_wu, f1_wd, f2_wg, f2_wu, f2_wd, xa_wq, xa_wk, xa_wv, xa_wo,
              w_in_even, w_out_even, shift_mu, decay_w0, decay_w2, iclr_a0, iclr_a2, gate_g2, k_k, k_a, r_k,
              lnx_w, lnx_b, conv_w, w_in_odd, w_out_odd, gm_ln_w, gm_ln_b, gm_ws, gm_bs):
    P = dict(norms=norms, final_norm=final_norm, f1_wg=f1_wg, f1_wu=f1_wu, f1_wd=f1_wd,
             f2_wg=f2_wg, f2_wu=f2_wu, f2_wd=f2_wd, xa_wq=xa_wq, xa_wo=xa_wo,
             w_in_even=w_in_even, w_out_even=w_out_even, shift_mu=shift_mu, decay_w0=decay_w0,
             decay_w2=decay_w2, iclr_a0=iclr_a0, iclr_a2=iclr_a2, gate_g2=gate_g2, k_k=k_k, k_a=k_a,
             r_k=r_k, lnx_w=lnx_w, lnx_b=lnx_b, conv_w=conv_w, w_in_odd=w_in_odd, w_out_odd=w_out_odd,
             gm_ln_w=gm_ln_w, gm_ln_b=gm_ln_b, gm_ws=gm_ws, gm_bs=gm_bs)
    bp = x_prompt.shape[0]
    new_mem_k_p = jnp.einsum('bmd,lde->lbme', mem_prompt, xa_wk).reshape(DEPTH, bp, N_MEM, XA_HEADS, XA_HEAD_DIM)
    new_mem_v_p = jnp.einsum('bmd,lde->lbme', mem_prompt, xa_wv).reshape(DEPTH, bp, N_MEM, XA_HEADS, XA_HEAD_DIM)
    shift0 = jnp.zeros((N_EVEN, bp, PROJ_A), x_prompt.dtype)
    wkv0 = jnp.zeros((N_EVEN, bp, N_HEADS_A, HEAD_A, HEAD_A), jnp.float32)
    conv0 = jnp.zeros((N_EVEN, bp, CONV_W - 1, MIX_B), x_prompt.dtype)
    y_prompt, p_sh, p_wkv, p_cv, _ = _trunk(x_prompt, new_mem_k_p, new_mem_v_p, shift0, wkv0, conv0, P)
    y_sample, s_sh, s_wkv, s_cv, s_v = _trunk(x_sample, cache_mem_k, cache_mem_v, state_shift, state_wkv,
                                              state_conv, P)
    new_shift_p = jnp.stack(p_sh)
    new_wkv_p = jnp.stack(p_wkv)
    new_conv_p = jnp.stack(p_cv)
    new_shift_s = jnp.stack(s_sh)
    new_wkv_s = jnp.stack(s_wkv)
    new_conv_s = jnp.stack(s_cv)
    new_gmlp_v_s = jnp.stack(s_v)
    return (y_prompt, y_sample, new_shift_p, new_wkv_p, new_conv_p, new_mem_k_p, new_mem_v_p,
            new_shift_s, new_wkv_s, new_conv_s, new_gmlp_v_s)
```

```cpp
#include <hip/hip_runtime.h>
#include <hip/hip_cooperative_groups.h>
#include <cstdio>
#include <cstdint>
namespace cg = cooperative_groups;
namespace pg8 {
#define PG8_LAS __attribute__((address_space(3)))
typedef unsigned short bf16_t;
typedef short bf16x8 __attribute__((ext_vector_type(8)));
typedef float f32x4 __attribute__((ext_vector_type(4)));
typedef unsigned u32x4 __attribute__((ext_vector_type(4)));
constexpr int BM = 256, BK = 64, HALF = 128, HTB = HALF * BK * 2  , STAGE_BYTES = 8 * HTB, NXCD = 8, WGM = 8;

__host__ __device__ __forceinline__ int lds_byte(int r, int c) { const int st = (r >> 4) * 2 + (c >> 5), rr = r & 15, cc = c & 31, ob = rr * 64 + cc * 2; return st * 1024 + (ob ^ (((ob >> 9) & 1) << 5)); }
__host__ __device__ __forceinline__ void stage_rc(int b, int& R, int& C) { const int st = b / 1024, sb = b % 1024, swz = sb ^ (((sb >> 9) & 1) << 5); R = (st >> 1) * 16 + swz / 64; C = (st & 1) * 32 + (swz % 64) / 2; }
__host__ __device__ __forceinline__ int perm32(int rho) { const int n = rho >> 4, i = rho & 15; return 8 * (i >> 2) + 4 * n + (i & 3); }

struct Unit { int pm, pn; };
struct Gemm { const bf16_t* A; const bf16_t* Bt; int M, N, K; };

struct StaticOrder {
    int nM, nN, nwg, G, c;
    __host__ __device__ void init(int M, int N, int G_, int c_) { nM = M / BM; nN = N / BM; nwg = nM * nN; G = G_; c = c_; }
    __host__ __device__ bool next(int i, Unit& u) const {
        const long L = (long)i * G + c; if (L >= nwg) return false;
        int wgid = (int)L; { const int q = nwg / NXCD, r = nwg % NXCD, xcd = wgid % NXCD, off = wgid / NXCD; wgid = (xcd < r ? xcd * (q + 1) : r * (q + 1) + (xcd - r) * q) + off; }
        const int nig = WGM * nN, gid = wgid / nig, fm = gid * WGM, gsz = (nM - fm) < WGM ? (nM - fm) : WGM;
        u.pm = fm + ((wgid % nig) % gsz); u.pn = (wgid % nig) / gsz; return true;
    }
    __device__ __forceinline__ void a_ready(const Unit&) const {}
    __device__ __forceinline__ void done(const Unit&) const {}
};

template <class Epi, class Sched, bool ALIGN_EPI = false, bool SP2 = false>
__device__ __forceinline__ void gemm_phase(PG8_LAS unsigned char* lds, const Gemm g, const Sched& S, const Epi& E, const int wave_in) {
    int lane; asm volatile("v_mbcnt_lo_u32_b32 %0, -1, 0\n\tv_mbcnt_hi_u32_b32 %0, -1, %0" : "=v"(lane)); const int wid = wave_in, tid = wid * 64 + lane, wr = wid >> 2, wc = wid & 3, fr = lane & 15, fq = lane >> 4;
    const int K = g.K, nt = K / BK;
    unsigned voffA[2], voffB[2];
#pragma unroll
    for (int i = 0; i < 2; ++i) { int R, C; stage_rc(tid * 16 + i * 8192, R, C); const int Rb = Epi::PERM ? ((R & ~31) + perm32(R & 31)) : R;
        voffA[i] = (unsigned)(R * K + C) * 2u; voffB[i] = (unsigned)(Rb * K + C) * 2u; }
    const size_t kstep = (size_t)(BK * 2);
    const size_t hstep = (size_t)HALF * K * 2;
    const size_t tstep = 2 * hstep;
    const unsigned ldsw = (unsigned)wid * 1024u;
    const int aoff = lds_byte(wr * 64 + fr, fq * 8), boff = lds_byte(wc * 32 + fr, fq * 8);
#define PG8_SA(b, h) (((b) * 2 + (h)) * HTB)
#define PG8_SB(b, h) ((4 + (b) * 2 + (h)) * HTB)
#define PG8_STAGE(bufoff, gbase, voff) do { _Pragma("unroll") for (int _i = 0; _i < 2; ++_i) \
        __builtin_amdgcn_global_load_lds((const unsigned*)((const char*)(gbase) + (voff)[_i]), (PG8_LAS unsigned*)(lds + (bufoff) + ldsw + _i * 8192), 16, 0, 0); } while (0)
#define PG8_LDA(dst, b, h) do { _Pragma("unroll") for (int m = 0; m < 4; ++m) _Pragma("unroll") for (int k = 0; k < 2; ++k) dst[m][k] = *(const PG8_LAS bf16x8*)(lds + PG8_SA(b, h) + aoff + m * 2048 + k * 1024); } while (0)
#define PG8_LDB(dst, b, h) do { _Pragma("unroll") for (int n = 0; n < 2; ++n) _Pragma("unroll") for (int k = 0; k < 2; ++k) dst[n][k] = *(const PG8_LAS bf16x8*)(lds + PG8_SB(b, h) + boff + n * 2048 + k * 1024); } while (0)
#define PG8_MMA(ai, bj, At, Bt) do { __builtin_amdgcn_s_setprio(1); _Pragma("unroll") for (int m = 0; m < 4; ++m) _Pragma("unroll") for (int n = 0; n < 2; ++n) _Pragma("unroll") for (int k = 0; k < 2; ++k) \
        acc[ai][bj][m][n] = __builtin_amdgcn_mfma_f32_16x16x32_bf16(Bt[n][k], At[m][k], acc[ai][bj][m][n], 0, 0, 0); __builtin_amdgcn_s_setprio(0); } while (0)
#define PG8_WAIT_V(n) asm volatile("s_waitcnt vmcnt(" #n ")" ::: "memory")
#define PG8_WAIT_L(n) asm volatile("s_waitcnt lgkmcnt(" #n ")" ::: "memory")
#define PG8_BAR __builtin_amdgcn_s_barrier()
#define PG8_SCHED __builtin_amdgcn_sched_barrier(0)
    Unit cur, nxt; int ui = 0;
    if (!S.next(0, cur)) return;
    f32x4 acc[2][2][4][2];
#pragma unroll
    for (int a = 0; a < 2; ++a)
#pragma unroll
        for (int b = 0; b < 2; ++b)
#pragma unroll
            for (int m = 0; m < 4; ++m)
#pragma unroll
                for (int n = 0; n < 2; ++n) acc[a][b][m][n] = (f32x4){0.f, 0.f, 0.f, 0.f};
    bf16x8 At[4][2], B0[2][2], B1[2][2];
    const char* cA = (const char*)g.A + (size_t)cur.pm * tstep; const char* cB = (const char*)g.Bt + (size_t)cur.pn * tstep;
    S.a_ready(cur);
    if constexpr (SP2) {
        PG8_STAGE(PG8_SB(0, 0), cB, voffB); PG8_STAGE(PG8_SB(0, 1), cB + hstep, voffB); PG8_STAGE(PG8_SA(0, 0), cA, voffA); PG8_STAGE(PG8_SA(0, 1), cA + hstep, voffA);
        if (wr == 1) PG8_BAR;
        PG8_WAIT_V(2); PG8_BAR;
        PG8_STAGE(PG8_SB(1, 0), cB + kstep, voffB); PG8_STAGE(PG8_SA(1, 0), cA + kstep, voffA); PG8_STAGE(PG8_SB(1, 1), cB + hstep + kstep, voffB);
        PG8_WAIT_V(6); PG8_BAR;
    } else {
        PG8_STAGE(PG8_SB(0, 0), cB, voffB); PG8_STAGE(PG8_SA(0, 0), cA, voffA); PG8_STAGE(PG8_SB(0, 1), cB + hstep, voffB); PG8_STAGE(PG8_SA(0, 1), cA + hstep, voffA);
        if (wr == 1) PG8_BAR;
        PG8_WAIT_V(4); PG8_BAR;
        PG8_STAGE(PG8_SB(1, 0), cB + kstep, voffB); PG8_STAGE(PG8_SA(1, 0), cA + kstep, voffA); PG8_STAGE(PG8_SB(1, 1), cB + hstep + kstep, voffB);
        PG8_WAIT_V(6); PG8_BAR;
    }
    for (;;) {
        const bool has_next = S.next(ui + 1, nxt);
        const char* nA = has_next ? (const char*)g.A + (size_t)nxt.pm * tstep : cA; const char* nB = has_next ? (const char*)g.Bt + (size_t)nxt.pn * tstep : cB;
        for (int t = 0; t < nt; t += 2) {
            const bool last = (t == nt - 2);
            const char* a1 = cA + (size_t)(t + 1) * kstep;
            const char* a2 = last ? nA : cA + (size_t)(t + 2) * kstep; const char* b2 = last ? nB : cB + (size_t)(t + 2) * kstep;
            const char* a3 = a2 + kstep; const char* b3 = b2 + kstep;
            if (last && has_next) S.a_ready(nxt);
            if constexpr (SP2) {
            PG8_LDB(B0, 0, 0); PG8_LDB(B1, 0, 1); PG8_SCHED; PG8_LDA(At, 0, 0); PG8_STAGE(PG8_SA(1, 1), a1 + hstep, voffA);
            PG8_WAIT_V(8); PG8_WAIT_L(0); PG8_BAR; PG8_MMA(0, 0, At, B0); PG8_MMA(0, 1, At, B1); PG8_BAR; PG8_SCHED;
            PG8_LDA(At, 0, 1); PG8_STAGE(PG8_SB(0, 0), b2, voffB); PG8_STAGE(PG8_SB(0, 1), b2 + hstep, voffB); PG8_STAGE(PG8_SA(0, 0), a2, voffA);
            PG8_WAIT_V(8); PG8_WAIT_L(0); PG8_BAR; PG8_MMA(1, 0, At, B0); PG8_MMA(1, 1, At, B1); PG8_BAR; PG8_SCHED;
            PG8_LDB(B0, 1, 0); PG8_LDB(B1, 1, 1); PG8_SCHED; PG8_LDA(At, 1, 0); PG8_STAGE(PG8_SA(0, 1), a2 + hstep, voffA);
            PG8_WAIT_V(8); PG8_WAIT_L(0); PG8_BAR; PG8_MMA(0, 0, At, B0); PG8_MMA(0, 1, At, B1); PG8_BAR; PG8_SCHED;
            PG8_LDA(At, 1, 1); PG8_STAGE(PG8_SB(1, 0), b3, voffB); PG8_STAGE(PG8_SB(1, 1), b3 + hstep, voffB); PG8_STAGE(PG8_SA(1, 0), a3, voffA);
            PG8_WAIT_V(8); PG8_WAIT_L(0); PG8_BAR; PG8_MMA(1, 0, At, B0); PG8_MMA(1, 1, At, B1); PG8_BAR; PG8_SCHED;
            } else {
            PG8_LDB(B0, 0, 0); PG8_SCHED; PG8_LDA(At, 0, 0); PG8_STAGE(PG8_SA(1, 1), a1 + hstep, voffA);
            PG8_WAIT_L(8); PG8_BAR; PG8_WAIT_L(0); PG8_MMA(0, 0, At, B0); PG8_BAR; PG8_SCHED;
            PG8_LDB(B1, 0, 1); PG8_STAGE(PG8_SB(0, 0), b2, voffB);
            PG8_BAR; PG8_WAIT_L(0); PG8_MMA(0, 1, At, B1); PG8_BAR;
            PG8_LDA(At, 0, 1); PG8_STAGE(PG8_SA(0, 0), a2, voffA);
            PG8_BAR; PG8_WAIT_L(0); PG8_MMA(1, 0, At, B0); PG8_BAR; PG8_SCHED;
            PG8_STAGE(PG8_SB(0, 1), b2 + hstep, voffB);
            PG8_WAIT_V(6); PG8_BAR; PG8_MMA(1, 1, At, B1); PG8_BAR;
            PG8_LDB(B0, 1, 0); PG8_SCHED; PG8_LDA(At, 1, 0); PG8_STAGE(PG8_SA(0, 1), a2 + hstep, voffA);
            PG8_WAIT_L(8); PG8_BAR; PG8_WAIT_L(0); PG8_MMA(0, 0, At, B0); PG8_BAR; PG8_SCHED;
            PG8_LDB(B1, 1, 1); PG8_STAGE(PG8_SB(1, 0), b3, voffB);
            PG8_BAR; PG8_WAIT_L(0); PG8_MMA(0, 1, At, B1); PG8_BAR;
            PG8_LDA(At, 1, 1); PG8_STAGE(PG8_SA(1, 0), a3, voffA);
            PG8_BAR; PG8_WAIT_L(0); PG8_MMA(1, 0, At, B0); PG8_BAR; PG8_SCHED;
            PG8_STAGE(PG8_SB(1, 1), b3 + hstep, voffB);
            PG8_WAIT_V(6); PG8_BAR; PG8_MMA(1, 1, At, B1); PG8_BAR;
            }
        }
        if constexpr (ALIGN_EPI) { if (wr == 0) PG8_BAR; }
        if constexpr (!Epi::AFTER_DRAIN) { E(acc, cur, wr, wc, fr, fq); S.done(cur); }
        if (!has_next) break;
#pragma unroll
        for (int a = 0; a < 2; ++a)
#pragma unroll
            for (int b = 0; b < 2; ++b)
#pragma unroll
                for (int m = 0; m < 4; ++m)
#pragma unroll
                    for (int n = 0; n < 2; ++n) acc[a][b][m][n] = (f32x4){0.f, 0.f, 0.f, 0.f};
        cur = nxt; cA = nA; cB = nB; ++ui;
        if constexpr (ALIGN_EPI) { if (wr == 1) PG8_BAR; }
    }
    PG8_WAIT_V(0);
    if constexpr (!ALIGN_EPI) { if (wr == 0) PG8_BAR; }
    PG8_BAR;
    if constexpr (Epi::AFTER_DRAIN) { E.fused(acc, cur, wr, wc, fr, fq, lds, wid, lane); S.done(cur); }
#undef PG8_SA
#undef PG8_SB
#undef PG8_STAGE
#undef PG8_LDA
#undef PG8_LDB
#undef PG8_MMA
#undef PG8_WAIT_V
#undef PG8_WAIT_L
#undef PG8_BAR
#undef PG8_SCHED
}
}

#define LAS __attribute__((address_space(3)))
typedef unsigned short bf16;
typedef float f32x4 __attribute__((ext_vector_type(4)));
typedef float f32x2 __attribute__((ext_vector_type(2)));
typedef short bf16x8 __attribute__((ext_vector_type(8)));
typedef short s16x4 __attribute__((ext_vector_type(4)));
typedef unsigned u32x4 __attribute__((ext_vector_type(4)));
typedef unsigned u32x2 __attribute__((ext_vector_type(2)));
typedef __bf16 bf16x2_t __attribute__((ext_vector_type(2)));

constexpr int NWAVES = 8, NTHR = 512;
constexpr int D = 1024, BATCH = 8, SEQ = 2048, DEC_B = 128, DEC_T = 4;
constexpr int MP = BATCH * SEQ, MS = DEC_B * DEC_T, M = MP + MS;
constexpr int FF = 2816, PA = 1792, PB = 1536, PINE = PA + PB, NMEM = 256, MMEM = BATCH * NMEM;
constexpr int NLORA = 1536, KLORA = 256;
constexpr float RMS_EPS = 1e-6f, LN_EPS = 1e-5f, GN_EPS = 64e-5f;
constexpr float QSCALE = 0.0625f * 1.4426950408889634f;

enum { I_XP = 0, I_XS, I_MEMP, I_SSHIFT, I_SWKV, I_SCONV, I_CK, I_CV, I_NORMS, I_FNORM, I_F1G, I_F1U, I_F1D, I_F2G, I_F2U, I_F2D,
       I_WQ, I_WK, I_WV, I_WO, I_WINE, I_WOUTE, I_MU, I_W0, I_W2, I_A0, I_A2, I_G2, I_KK, I_KA, I_RK, I_LNXW, I_LNXB, I_CONVW,
       I_WINO, I_WOUTO, I_GLNW, I_GLNB, I_GWS, I_GBS, N_IN };
constexpr size_t O_YP = 0, O_YS = O_YP + (size_t)MP * D, O_SHP = O_YS + (size_t)MS * D, O_WKVP = O_SHP + BATCH * PA,
                 O_CVP = O_WKVP + (size_t)BATCH * 8 * 64 * 64, O_MKP = O_CVP + BATCH * 2 * 512, O_MVP = O_MKP + (size_t)2 * MMEM * D,
                 O_SHS = O_MVP + (size_t)2 * MMEM * D, O_WKVS = O_SHS + (size_t)DEC_B * PA, O_CVS = O_WKVS + (size_t)DEC_B * 8 * 64 * 64,
                 O_GVS = O_CVS + (size_t)DEC_B * 2 * 512, O_END = O_GVS + (size_t)MS * D;
static_assert(O_END == 31053824, "output size");

constexpr size_t al(size_t x) { return (x + 0xFFFFF) & ~(size_t)0xFFFFF; }
constexpr size_t WS_WUP = 0;
constexpr size_t SZ_WUP = (size_t)2 * FF * D * 2;
constexpr size_t WS_WDN = WS_WUP + al(4 * SZ_WUP);
constexpr size_t SZ_WDN = (size_t)D * FF * 2;
constexpr size_t WS_WQ = WS_WDN + al(4 * SZ_WDN);
constexpr size_t SZ_DD = (size_t)D * D * 2;
constexpr size_t WS_WO = WS_WQ + al(2 * SZ_DD);
constexpr size_t WS_WKV = WS_WO + al(2 * SZ_DD);
constexpr size_t WS_WINE = WS_WKV + al(4 * SZ_DD);
constexpr size_t WS_WINO = WS_WINE + al((size_t)PINE * D * 2);
constexpr size_t WS_WOUTE = WS_WINO + al(2 * SZ_DD);
constexpr size_t WS_WOUTO = WS_WOUTE + al(SZ_DD);
constexpr size_t WS_LW = WS_WOUTO + al(SZ_DD);
constexpr size_t WS_X = WS_LW + al((size_t)NLORA * KLORA * 2);
constexpr size_t WS_XB = WS_X + al((size_t)M * D * 4);
constexpr size_t WS_HB = WS_XB + al((size_t)M * D * 2);
constexpr size_t WS_P = WS_HB + al((size_t)M * FF * 2);
constexpr size_t WS_RKV = WS_P + al((size_t)M * PINE * 4);
constexpr size_t WS_AL = WS_RKV + al((size_t)M * 1536 * 4);
constexpr size_t WS_LO = WS_AL + al((size_t)M * KLORA * 2);
constexpr size_t WS_SI3 = WS_LO + al((size_t)M * NLORA * 4);
constexpr size_t WS_YRAW = WS_SI3 + al((size_t)M * 1536 * 4);
constexpr size_t WS_YAB = WS_YRAW + al((size_t)M * 512 * 4);
constexpr size_t WS_Q = WS_YAB + al((size_t)M * D * 2);
constexpr size_t WS_O = WS_Q + al((size_t)M * D * 2);
constexpr size_t WS_MEMB = WS_O + al((size_t)M * D * 2);
constexpr size_t WS_KB = WS_MEMB + al((size_t)MMEM * D * 2);
constexpr size_t WS_VT = WS_KB + al((size_t)2 * MMEM * D * 2);
constexpr size_t WS_SS = WS_VT + al((size_t)2 * MMEM * D * 2);
constexpr size_t WS_LB = WS_SS + al((size_t)11 * M * 4);
constexpr size_t WS_BAR = WS_LB + al(1536 * 4);
constexpr size_t WS_END = WS_BAR + al(256);

constexpr int LDS_BYTES = 147456;

__device__ __forceinline__ unsigned pk2(float lo, float hi) { f32x2 v = {lo, hi}; bf16x2_t b = __builtin_convertvector(v, bf16x2_t); return __builtin_bit_cast(unsigned, b); }
__device__ __forceinline__ float wave_sum(float v) {
#pragma unroll
    for (int o = 1; o < 64; o <<= 1) v += __shfl_xor(v, o);
    return v;
}
__device__ __forceinline__ float wave_max(float v) {
#pragma unroll
    for (int o = 1; o < 64; o <<= 1) v = fmaxf(v, __shfl_xor(v, o));
    return v;
}
__device__ __forceinline__ float fast_rcp(float x) { return __builtin_amdgcn_rcpf(x); }
__device__ __forceinline__ float sigmoidf_(float x) { return fast_rcp(1.f + __expf(-x)); }
__device__ __forceinline__ float siluf_(float x) { return x * fast_rcp(1.f + __expf(-x)); }
__device__ __forceinline__ float geluf_(float x) { return 0.5f * x * (1.f + erff(x * 0.70710678118654752f)); }
#define MFMA16(a, b, c) __builtin_amdgcn_mfma_f32_16x16x32_bf16((a), (b), (c), 0, 0, 0)

namespace pg8 {
struct EpiSwiGLU {
    static constexpr bool PERM = true, AFTER_DRAIN = false;
    bf16_t* H; const float* ss;
    __device__ __forceinline__ void operator()(const f32x4 (&acc)[2][2][4][2], const Unit& u, int wr, int wc, int fr, int fq) const {
        const int row0 = u.pm * BM + wr * 64 + fr, col0 = u.pn * 128 + wc * 32 + 8 * fq;
#pragma unroll
        for (int ai = 0; ai < 2; ++ai)
#pragma unroll
            for (int m = 0; m < 4; ++m) {
                const int row = row0 + ai * HALF + m * 16; const float r = rsqrtf(ss[row] * (1.f / 1024.f) + 1e-6f);
                float hv[8];
#pragma unroll
                for (int n = 0; n < 2; ++n)
#pragma unroll
                    for (int j = 0; j < 4; ++j) { const float g = acc[ai][0][m][n][j] * r, uu = acc[ai][1][m][n][j] * r; hv[4 * n + j] = siluf_(g) * uu; }
                u32x4 w; w.x = pk2(hv[0], hv[1]); w.y = pk2(hv[2], hv[3]); w.z = pk2(hv[4], hv[5]); w.w = pk2(hv[6], hv[7]);
                *(u32x4*)(H + (size_t)row * 2816 + col0) = w;
            }
    }
};
struct EpiResid {
    static constexpr bool PERM = true, AFTER_DRAIN = false;
    float* X; bf16_t* XB; float* ssn; float scale;
    __device__ __forceinline__ void operator()(const f32x4 (&acc)[2][2][4][2], const Unit& u, int wr, int wc, int fr, int fq) const {
        const int row0 = u.pm * BM + wr * 64 + fr, col0 = u.pn * BM + wc * 32 + 8 * fq;
#pragma unroll
        for (int ai = 0; ai < 2; ++ai)
#pragma unroll
            for (int m = 0; m < 4; ++m) {
                const int row = row0 + ai * HALF + m * 16; float sq = 0.f;
#pragma unroll
                for (int bj = 0; bj < 2; ++bj) {
                    float* xp = X + (size_t)row * 1024 + col0 + bj * HALF;
                    f32x4 x0 = *(const f32x4*)xp, x1 = *(const f32x4*)(xp + 4);
                    x0 += acc[ai][bj][m][0] * scale; x1 += acc[ai][bj][m][1] * scale;
                    *(f32x4*)xp = x0; *(f32x4*)(xp + 4) = x1;
                    u32x4 w; w.x = pk2(x0[0], x0[1]); w.y = pk2(x0[2], x0[3]); w.z = pk2(x1[0], x1[1]); w.w = pk2(x1[2], x1[3]);
                    *(u32x4*)(XB + (size_t)row * 1024 + col0 + bj * HALF) = w;
                    sq += (x0[0] * x0[0] + x0[1] * x0[1]) + (x0[2] * x0[2] + x0[3] * x0[3]) + (x1[0] * x1[0] + x1[1] * x1[1]) + (x1[2] * x1[2] + x1[3] * x1[3]);
                }
                sq += __shfl_xor(sq, 16); sq += __shfl_xor(sq, 32);
                if (fq == 0) unsafeAtomicAdd(ssn + row, sq);
            }
    }
};
template <int ACT> struct EpiF32 {
    static constexpr bool PERM = true, AFTER_DRAIN = false;
    float* O; int ldc; const float* ss; float* vs; float* vq;
    __device__ __forceinline__ void operator()(const f32x4 (&acc)[2][2][4][2], const Unit& u, int wr, int wc, int fr, int fq) const {
        const int row0 = u.pm * BM + wr * 64 + fr, col0 = u.pn * BM + wc * 32 + 8 * fq;
#pragma unroll
        for (int ai = 0; ai < 2; ++ai)
#pragma unroll
            for (int m = 0; m < 4; ++m) {
                const int row = row0 + ai * HALF + m * 16; const float r = rsqrtf(ss[row] * (1.f / 1024.f) + 1e-6f);
                float s1 = 0.f, s2 = 0.f;
#pragma unroll
                for (int bj = 0; bj < 2; ++bj) {
                    f32x4 v0 = acc[ai][bj][m][0] * r, v1 = acc[ai][bj][m][1] * r;
                    if (ACT == 1) {
#pragma unroll
                        for (int j = 0; j < 4; ++j) { v0[j] = geluf_(v0[j]); v1[j] = geluf_(v1[j]); }
                        s1 += (v0[0] + v0[1]) + (v0[2] + v0[3]) + (v1[0] + v1[1]) + (v1[2] + v1[3]);
                        s2 += (v0[0] * v0[0] + v0[1] * v0[1]) + (v0[2] * v0[2] + v0[3] * v0[3]) + (v1[0] * v1[0] + v1[1] * v1[1]) + (v1[2] * v1[2] + v1[3] * v1[3]);
                    }
                    float* op = O + (size_t)row * ldc + col0 + bj * HALF;
                    *(f32x4*)op = v0; *(f32x4*)(op + 4) = v1;
                }
                if (ACT == 1 && u.pn >= 4) {
                    s1 += __shfl_xor(s1, 16); s1 += __shfl_xor(s1, 32); s2 += __shfl_xor(s2, 16); s2 += __shfl_xor(s2, 32);
                    if (fq == 0) { unsafeAtomicAdd(vs + row, s1); unsafeAtomicAdd(vq + row, s2); }
                }
            }
    }
};
struct EpiBf16 {
    static constexpr bool PERM = true, AFTER_DRAIN = false;
    bf16_t* O; int ldc; const float* ss; float scale;
    __device__ __forceinline__ void operator()(const f32x4 (&acc)[2][2][4][2], const Unit& u, int wr, int wc, int fr, int fq) const {
        const int row0 = u.pm * BM + wr * 64 + fr, col0 = u.pn * BM + wc * 32 + 8 * fq;
#pragma unroll
        for (int ai = 0; ai < 2; ++ai)
#pragma unroll
            for (int m = 0; m < 4; ++m) {
                const int row = row0 + ai * HALF + m * 16; const float r = ss ? rsqrtf(ss[row] * (1.f / 1024.f) + 1e-6f) * scale : scale;
#pragma unroll
                for (int bj = 0; bj < 2; ++bj) {
                    const f32x4 v0 = acc[ai][bj][m][0] * r, v1 = acc[ai][bj][m][1] * r;
                    u32x4 w; w.x = pk2(v0[0], v0[1]); w.y = pk2(v0[2], v0[3]); w.z = pk2(v1[0], v1[1]); w.w = pk2(v1[2], v1[3]);
                    *(u32x4*)(O + (size_t)row * ldc + col0 + bj * HALF) = w;
                }
            }
    }
};
struct EpiLoRA {
    static constexpr bool PERM = true, AFTER_DRAIN = false;
    float* O; const float* lb;
    __device__ __forceinline__ void operator()(const f32x4 (&acc)[2][2][4][2], const Unit& u, int wr, int wc, int fr, int fq) const {
        const int row0 = u.pm * BM + wr * 64 + fr, col0 = u.pn * BM + wc * 32 + 8 * fq;
#pragma unroll
        for (int bj = 0; bj < 2; ++bj) {
            const int c = col0 + bj * HALF; const f32x4 b0 = *(const f32x4*)(lb + c), b1 = *(const f32x4*)(lb + c + 4);
#pragma unroll
            for (int ai = 0; ai < 2; ++ai)
#pragma unroll
                for (int m = 0; m < 4; ++m) {
                    const int row = row0 + ai * HALF + m * 16; float* op = O + (size_t)row * 1536 + c;
                    *(f32x4*)op = acc[ai][bj][m][0] + b0; *(f32x4*)(op + 4) = acc[ai][bj][m][1] + b1;
                    asm volatile("" ::: "memory");
                }
        }
    }
};
struct EpiKV {
    static constexpr bool PERM = true, AFTER_DRAIN = false;
    float* OK; float* OV; bf16_t* KB;
    __device__ __forceinline__ void operator()(const f32x4 (&acc)[2][2][4][2], const Unit& u, int wr, int wc, int fr, int fq) const {
        const int l = u.pn >> 3, kv = (u.pn >> 2) & 1; const int row0 = u.pm * BM + wr * 64 + fr, col0 = (u.pn & 3) * BM + wc * 32 + 8 * fq;
        float* ob = (kv ? OV : OK) + (size_t)l * 2048 * 1024;
#pragma unroll
        for (int ai = 0; ai < 2; ++ai)
#pragma unroll
            for (int m = 0; m < 4; ++m) {
                const int row = row0 + ai * HALF + m * 16;
#pragma unroll
                for (int bj = 0; bj < 2; ++bj) {
                    const f32x4 v0 = acc[ai][bj][m][0], v1 = acc[ai][bj][m][1];
                    float* op = ob + (size_t)row * 1024 + col0 + bj * HALF; *(f32x4*)op = v0; *(f32x4*)(op + 4) = v1;
                    if (kv == 0) { u32x4 w; w.x = pk2(v0[0], v0[1]); w.y = pk2(v0[2], v0[3]); w.z = pk2(v1[0], v1[1]); w.w = pk2(v1[2], v1[3]);
                        *(u32x4*)(KB + ((size_t)l * 2048 + row) * 1024 + col0 + bj * HALF) = w; }
                }
            }
    }
};
}

struct Args { const float* in[N_IN]; float* out; unsigned char* ws; int ph_lo, ph_hi; };
struct Ctx {
    unsigned char* lds; int wave, G, bid, gw, ngw;
    const float* const* in; float* out; unsigned char* ws;
};
__device__ __forceinline__ int lane_id_fresh() { int l; asm volatile("v_mbcnt_lo_u32_b32 %0, -1, 0\n\tv_mbcnt_hi_u32_b32 %0, -1, %0" : "=v"(l)); return l; }
#define LANE_TID const int LANE = lane_id_fresh(), TID = C.wave * 64 + LANE; (void)TID
#define WSP(T, off) ((T*)(C.ws + (off)))
#define SSA(i) (WSP(float, WS_SS) + (size_t)(i) * M)

__device__ __forceinline__ void tr_item(const float* W, int N, bf16* WT, int ldk, int k0, int n0, int drow0, const float* gain, float* scr, int lane) {
#pragma unroll 8
    for (int i = 0; i < 32; ++i) { const int kk = 2 * i + (lane >> 5); float v = W[(size_t)(k0 + kk) * N + n0 + (lane & 31)]; if (gain) v *= gain[k0 + kk]; scr[kk * 33 + (lane & 31)] = v; }
    __builtin_amdgcn_s_waitcnt(0); asm volatile("" ::: "memory");
    const int c = lane & 7;
#pragma unroll
    for (int j = 0; j < 4; ++j) { const int n = (lane >> 3) + 8 * j; const float* s = scr + (8 * c) * 33 + n;
        u32x4 o; o.x = pk2(s[0 * 33], s[1 * 33]); o.y = pk2(s[2 * 33], s[3 * 33]); o.z = pk2(s[4 * 33], s[5 * 33]); o.w = pk2(s[6 * 33], s[7 * 33]);
        *(u32x4*)(WT + (size_t)(drow0 + n) * ldk + k0 + 8 * c) = o; }
    __builtin_amdgcn_s_waitcnt(0); asm volatile("" ::: "memory");
}
__device__ __forceinline__ void tr_job(const Ctx& C, const int LANE, int& cum, const float* W, int K, int N, bf16* WT, int roff, const float* gain, int mode) {
    const int nblk = N / 32, items = (K / 64) * nblk;
    int it = (C.gw + C.ngw - (cum % C.ngw)) % C.ngw;
    float* scr = (float*)(C.lds + C.wave * 16384);
    for (; it < items; it += C.ngw) {
        const int kb = it / nblk, nb = it % nblk, n0 = nb * 32;
        const int drow0 = mode == 0 ? roff + n0 : (n0 / 128) * 256 + (mode - 1) * 128 + (n0 % 128);
        tr_item(W, N, WT, K, kb * 64, n0, drow0, gain, scr, LANE);
    }
    cum += items;
}
__device__ __forceinline__ void phase_prologue(const Ctx& C) {
    LANE_TID;
    int cum = 0;
    const float* norms = C.in[I_NORMS];
    for (int l = 0; l < 2; ++l) {
        for (int f = 0; f < 2; ++f) {
            const float* gain = norms + (l * 4 + (f ? 3 : 0)) * 1024;
            bf16* wup = WSP(bf16, WS_WUP) + (size_t)(l * 2 + f) * (2 * FF * D);
            tr_job(C, LANE, cum, C.in[f ? I_F2G : I_F1G] + (size_t)l * D * FF, D, FF, wup, 0, gain, 1);
            tr_job(C, LANE, cum, C.in[f ? I_F2U : I_F1U] + (size_t)l * D * FF, D, FF, wup, 0, gain, 2);
            tr_job(C, LANE, cum, C.in[f ? I_F2D : I_F1D] + (size_t)l * D * FF, FF, D, WSP(bf16, WS_WDN) + (size_t)(l * 2 + f) * (D * FF), 0, nullptr, 0);
        }
        tr_job(C, LANE, cum, C.in[I_WQ] + (size_t)l * D * D, D, D, WSP(bf16, WS_WQ) + (size_t)l * D * D, 0, norms + (l * 4 + 2) * 1024, 0);
        tr_job(C, LANE, cum, C.in[I_WO] + (size_t)l * D * D, D, D, WSP(bf16, WS_WO) + (size_t)l * D * D, 0, nullptr, 0);
        tr_job(C, LANE, cum, C.in[I_WK] + (size_t)l * D * D, D, D, WSP(bf16, WS_WKV) + (size_t)(2 * l) * D * D, 0, nullptr, 0);
        tr_job(C, LANE, cum, C.in[I_WV] + (size_t)l * D * D, D, D, WSP(bf16, WS_WKV) + (size_t)(2 * l + 1) * D * D, 0, nullptr, 0);
    }
    tr_job(C, LANE, cum, C.in[I_WINE], D, PINE, WSP(bf16, WS_WINE), 0, norms + (0 * 4 + 1) * 1024, 0);
    tr_job(C, LANE, cum, C.in[I_WOUTE], D, D, WSP(bf16, WS_WOUTE), 0, nullptr, 0);
    tr_job(C, LANE, cum, C.in[I_WINO], D, 2 * D, WSP(bf16, WS_WINO), 0, norms + (1 * 4 + 1) * 1024, 0);
    tr_job(C, LANE, cum, C.in[I_WOUTO], D, D, WSP(bf16, WS_WOUTO), 0, nullptr, 0);
    { bf16* lw = WSP(bf16, WS_LW); const float* w2 = C.in[I_W2]; const float* a2 = C.in[I_A2]; const float* g2 = C.in[I_G2];
      for (int idx = C.bid * NTHR + TID; idx < NLORA * KLORA; idx += C.G * NTHR) {
          const int n = idx >> 8, k = idx & 255; float v = 0.f;
          if (n < 512) { if (k < 64) v = w2[k * 512 + n]; }
          else if (n < 1024) { if (k >= 64 && k < 128) v = a2[(k - 64) * 512 + (n - 512)]; }
          else { if (k >= 128) v = g2[(k - 128) * 512 + (n - 1024)]; }
          lw[idx] = (bf16)(pk2(v, 0.f) & 0xffffu);
      } }
    { float* lbv = WSP(float, WS_LB); for (int idx = C.bid * NTHR + TID; idx < NLORA; idx += C.G * NTHR) lbv[idx] = idx < 512 ? C.in[I_W0][idx] : (idx < 1024 ? C.in[I_A0][idx - 512] : 0.f); }
    if (C.bid == 0 && TID == 0) *WSP(unsigned, WS_BAR) = 0u;
    { float* X = WSP(float, WS_X); bf16* XB = WSP(bf16, WS_XB); float* ss0 = SSA(0);
      for (int m = C.gw; m < M; m += C.ngw) {
          const float* src = m < MP ? C.in[I_XP] + (size_t)m * D : C.in[I_XS] + (size_t)(m - MP) * D;
          float s = 0.f;
#pragma unroll
          for (int j = 0; j < 4; ++j) { const f32x4 v = ((const f32x4*)src)[64 * j + LANE]; ((f32x4*)(X + (size_t)m * D))[64 * j + LANE] = v;
              u32x2 w; w.x = pk2(v[0], v[1]); w.y = pk2(v[2], v[3]); ((u32x2*)(XB + (size_t)m * D))[64 * j + LANE] = w;
              s += (v[0] * v[0] + v[1] * v[1]) + (v[2] * v[2] + v[3] * v[3]); }
          s = wave_sum(s); if (LANE == 0) ss0[m] = s;
      } }
    { bf16* MB = WSP(bf16, WS_MEMB); const float* src = C.in[I_MEMP];
      for (int m = C.gw; m < MMEM; m += C.ngw) {
#pragma unroll
          for (int j = 0; j < 4; ++j) { const f32x4 v = ((const f32x4*)(src + (size_t)m * D))[64 * j + LANE];
              u32x2 w; w.x = pk2(v[0], v[1]); w.y = pk2(v[2], v[3]); ((u32x2*)(MB + (size_t)m * D))[64 * j + LANE] = w; }
      } }
    { float* z = SSA(1); for (int idx = C.bid * NTHR + TID; idx < 10 * M; idx += C.G * NTHR) z[idx] = 0.f; }
}

__device__ __forceinline__ void phase_shift_conv(const Ctx& C) {
    LANE_TID;
    const float* P = WSP(float, WS_P); float* RKV = WSP(float, WS_RKV); bf16* AL = WSP(bf16, WS_AL); bf16* YAB = WSP(bf16, WS_YAB);
    const float* mu = C.in[I_MU]; const float* cw = C.in[I_CONVW];
    for (int m = C.gw; m < M; m += C.ngw) {
        const bool pr = m < MP; const int b = pr ? m / SEQ : (m - MP) / DEC_T, t = pr ? m % SEQ : (m - MP) % DEC_T, T = pr ? SEQ : DEC_T;
        const float* prow = P + (size_t)m * PINE;
        const float* pprev = t > 0 ? prow - PINE : (pr ? nullptr : C.in[I_SSHIFT] + (size_t)b * PA);
        float* shout = C.out + (pr ? O_SHP : O_SHS) + (size_t)b * PA;
#pragma unroll
        for (int j = 0; j < 7; ++j) {
            const int i = 64 * j + LANE;
            const f32x4 pc = ((const f32x4*)prow)[i]; const f32x4 pp = pprev ? ((const f32x4*)pprev)[i] : (f32x4){0.f, 0.f, 0.f, 0.f};
            const f32x4 mm = ((const f32x4*)mu)[i]; const f32x4 ps = pc + mm * (pp - pc);
            if (t == T - 1) ((f32x4*)shout)[i] = pc;
            if (i < 384) ((f32x4*)(RKV + (size_t)m * 1536))[i] = ps;
            else { const int c = 4 * i - 1536; float v[4];
#pragma unroll
                for (int e = 0; e < 4; ++e) v[e] = c < 64 ? tanhf(ps[e]) : (c < 128 ? ps[e] : sigmoidf_(ps[e]));
                u32x2 w; w.x = pk2(v[0], v[1]); w.y = pk2(v[2], v[3]); *(u32x2*)(AL + (size_t)m * KLORA + c) = w; }
        }
        float* cvout = C.out + (pr ? O_CVP : O_CVS) + (size_t)b * 1024;
#pragma unroll
        for (int j = 0; j < 2; ++j) {
            const int i = 64 * j + LANE;
            const f32x4 h0 = ((const f32x4*)(prow + PA))[i], bg = ((const f32x4*)(prow + PA + 512))[i], c0 = ((const f32x4*)(prow + PA + 1024))[i];
            const f32x4 z0 = c0 * h0; f32x4 z1 = {0.f, 0.f, 0.f, 0.f}, z2 = {0.f, 0.f, 0.f, 0.f};
            if (t >= 1) { const float* q = prow - PINE; z1 = ((const f32x4*)(q + PA + 1024))[i] * ((const f32x4*)(q + PA))[i]; }
            else if (!pr) z1 = ((const f32x4*)(C.in[I_SCONV] + (size_t)b * 1024 + 512))[i];
            if (t >= 2) { const float* q = prow - 2 * PINE; z2 = ((const f32x4*)(q + PA + 1024))[i] * ((const f32x4*)(q + PA))[i]; }
            else if (!pr) z2 = ((const f32x4*)(C.in[I_SCONV] + (size_t)b * 1024 + (t == 1 ? 512 : 0)))[i];
            const f32x4 w0 = ((const f32x4*)cw)[i], w1 = ((const f32x4*)(cw + 512))[i], w2 = ((const f32x4*)(cw + 1024))[i];
            const f32x4 y = bg * (w0 * z2 + w1 * z1 + w2 * z0);
            u32x2 w; w.x = pk2(y[0], y[1]); w.y = pk2(y[2], y[3]); *(u32x2*)(YAB + (size_t)m * D + 512 + 4 * i) = w;
            if (t == T - 2) ((f32x4*)cvout)[i] = z0;
            if (t == T - 1) ((f32x4*)(cvout + 512))[i] = z0;
        }
    }
}
__device__ __forceinline__ void phase_scan_prep(const Ctx& C) {
    LANE_TID;
    const float* RKV = WSP(float, WS_RKV); float* LO = WSP(float, WS_LO); float* SI3 = WSP(float, WS_SI3);
    const float* kkw = C.in[I_KK]; const float* kaw = C.in[I_KA];
    const int c0 = LANE * 8, head = LANE >> 3, j0 = (LANE & 7) * 8;
    float kkv[8], kav[8];
#pragma unroll
    for (int e = 0; e < 8; ++e) { kkv[e] = kkw[c0 + e]; kav[e] = kaw[c0 + e]; }
    for (int m = C.gw; m < M; m += C.ngw) {
        const f32x4 k0 = *(const f32x4*)(RKV + (size_t)m * 1536 + 512 + c0), k1 = *(const f32x4*)(RKV + (size_t)m * 1536 + 512 + c0 + 4);
        const f32x4 a0 = *(const f32x4*)(LO + (size_t)m * 1536 + 512 + c0), a1 = *(const f32x4*)(LO + (size_t)m * 1536 + 512 + c0 + 4);
        float k[8] = {k0[0], k0[1], k0[2], k0[3], k1[0], k1[1], k1[2], k1[3]}, a[8] = {a0[0], a0[1], a0[2], a0[3], a1[0], a1[1], a1[2], a1[3]};
#pragma unroll
        for (int e = 0; e < 8; ++e) a[e] = sigmoidf_(a[e]);
        { f32x4 w0v = *(const f32x4*)(LO + (size_t)m * 1536 + c0), w1v = *(const f32x4*)(LO + (size_t)m * 1536 + c0 + 4);
#pragma unroll
          for (int e = 0; e < 4; ++e) {
              { const float nz = -w0v[e]; const float sp = fmaxf(nz, 0.f) + __logf(1.f + __expf(-fabsf(nz))); w0v[e] = __expf(-__expf(-sp - 0.5f)); }
              { const float nz = -w1v[e]; const float sp = fmaxf(nz, 0.f) + __logf(1.f + __expf(-fabsf(nz))); w1v[e] = __expf(-__expf(-sp - 0.5f)); } }
          *(f32x4*)(LO + (size_t)m * 1536 + c0) = w0v; *(f32x4*)(LO + (size_t)m * 1536 + c0 + 4) = w1v; }
        float kk[8], sq = 0.f;
#pragma unroll
        for (int e = 0; e < 8; ++e) { kk[e] = k[e] * kkv[e]; sq += kk[e] * kk[e]; }
        sq += __shfl_xor(sq, 1); sq += __shfl_xor(sq, 2); sq += __shfl_xor(sq, 4);
        const float inv = 1.f / fmaxf(sqrtf(sq), 1e-12f);
        float kp[8], av[8], bv[8];
#pragma unroll
        for (int e = 0; e < 8; ++e) { kk[e] *= inv; kp[e] = k[e] * (1.f + (a[e] - 1.f) * kav[e]); av[e] = -kk[e]; bv[e] = kk[e] * a[e]; }
        float* o = SI3 + (size_t)m * 1536 + head * 192 + j0;
        *(f32x4*)(o) = (f32x4){kp[0], kp[1], kp[2], kp[3]}; *(f32x4*)(o + 4) = (f32x4){kp[4], kp[5], kp[6], kp[7]};
        *(f32x4*)(o + 64) = (f32x4){av[0], av[1], av[2], av[3]}; *(f32x4*)(o + 68) = (f32x4){av[4], av[5], av[6], av[7]};
        *(f32x4*)(o + 128) = (f32x4){bv[0], bv[1], bv[2], bv[3]}; *(f32x4*)(o + 132) = (f32x4){bv[4], bv[5], bv[6], bv[7]};
    }
}
#define DPP_ADD(x, ctrl) ((x) + __builtin_bit_cast(float, __builtin_amdgcn_update_dpp(0, __builtin_bit_cast(int, (x)), (ctrl), 0xf, 0xf, true)))
__device__ __forceinline__ float allreduce16(float x) {
    x = DPP_ADD(x, 0xB1);
    x = DPP_ADD(x, 0x4E);
    x = DPP_ADD(x, 0x141);
    x = DPP_ADD(x, 0x140);
    return x;
}
__device__ __forceinline__ const f32x4* scan_src(const float* RKV, const float* LO, const float* SI3, size_t rowb, int h, int q, int idx) {
    const int st = idx / 84, e = idx % 84; const size_t row = rowb + st;
    const float* p = e < 16 ? RKV + row * 1536 + h * 64 + e * 4 : (e < 32 ? LO + row * 1536 + h * 64 + (e - 16) * 4 :
                     (e < 80 ? SI3 + row * 1536 + h * 192 + (e - 32) * 4 : RKV + row * 1536 + 1024 + h * 64 + q * 16 + (e - 80) * 4));
    return (const f32x4*)p;
}
__device__ __forceinline__ void phase_scan(const Ctx& C) {
    LANE_TID;
    const float* RKV = WSP(float, WS_RKV); const float* LO = WSP(float, WS_LO); const float* SI3 = WSP(float, WS_SI3); float* YRAW = WSP(float, WS_YRAW);
    const int i4 = LANE >> 4, kq = LANE & 15;
    constexpr int CH = 32, SW = 336, NE = 84;
    float* buf = (float*)C.lds;
    for (int item = C.bid; item < BATCH * 8 * 4; item += C.G) {
        const int seq = item >> 2, q = item & 3, b = seq >> 3, h = seq & 7;
        const size_t rowb = (size_t)b * SEQ;
#define srcp(idx) scan_src(RKV, LO, SI3, rowb, h, q, (idx))
        f32x4 ld[6];
        __syncthreads();
#pragma unroll
        for (int j = 0; j < 6; ++j) { const int idx = TID + NTHR * j; if (idx < CH * NE) ((f32x4*)buf)[idx] = *srcp(idx); }
        __syncthreads();
        f32x4 s4 = {0.f, 0.f, 0.f, 0.f};
        float* yout = YRAW + rowb * 512 + h * 64 + q * 16 + C.wave * 4 + i4;
        for (int c = 0; c < SEQ / CH; ++c) {
            if (c + 1 < SEQ / CH) {
#pragma unroll
                for (int j = 0; j < 6; ++j) { const int idx = TID + NTHR * j; if (idx < CH * NE) ld[j] = *srcp((c + 1) * CH * NE + idx); }
            }
            if (C.wave < 4) {
                const float* cb = buf + (c & 1) * (CH * SW);
#pragma unroll 4
                for (int st = 0; st < CH; ++st) {
                    const float* sp = cb + st * SW;
                    const f32x4 r4 = *(const f32x4*)(sp + 4 * kq), w4 = *(const f32x4*)(sp + 64 + 4 * kq), k4 = *(const f32x4*)(sp + 128 + 4 * kq),
                                a4 = *(const f32x4*)(sp + 192 + 4 * kq), b4 = *(const f32x4*)(sp + 256 + 4 * kq);
                    const float v = sp[320 + C.wave * 4 + i4];
                    float sa = (s4[0] * a4[0] + s4[1] * a4[1]) + (s4[2] * a4[2] + s4[3] * a4[3]);
                    sa = allreduce16(sa);
                    s4 = s4 * w4 + (b4 * sa + k4 * v);
                    float y = (s4[0] * r4[0] + s4[1] * r4[1]) + (s4[2] * r4[2] + s4[3] * r4[3]);
                    y = allreduce16(y);
                    if (kq == 0) yout[(size_t)(c * CH + st) * 512] = y;
                }
            }
            if (c + 1 < SEQ / CH) {
                float* nb = buf + ((c + 1) & 1) * (CH * SW);
#pragma unroll
                for (int j = 0; j < 6; ++j) { const int idx = TID + NTHR * j; if (idx < CH * NE) ((f32x4*)nb)[idx] = ld[j]; }
            }
            __syncthreads();
        }
        if (C.wave < 4) *(f32x4*)(C.out + O_WKVP + ((size_t)seq * 64 + q * 16 + C.wave * 4 + i4) * 64 + 4 * kq) = s4;
    }
    for (int job = C.gw; job < DEC_B * 8 * 16; job += C.ngw) {
        const int seq = job >> 4, rg = job & 15, b = seq >> 3, h = seq & 7, vi = rg * 4 + i4;
        f32x4 s4 = *(const f32x4*)(C.in[I_SWKV] + ((size_t)seq * 64 + vi) * 64 + 4 * kq);
#pragma unroll
        for (int t = 0; t < DEC_T; ++t) {
            const size_t row = (size_t)MP + b * DEC_T + t;
            const f32x4 r4 = *(const f32x4*)(RKV + row * 1536 + h * 64 + 4 * kq), w4 = *(const f32x4*)(LO + row * 1536 + h * 64 + 4 * kq);
            const float* sp = SI3 + row * 1536 + h * 192 + 4 * kq;
            const f32x4 k4 = *(const f32x4*)sp, a4 = *(const f32x4*)(sp + 64), b4 = *(const f32x4*)(sp + 128);
            const float v = RKV[row * 1536 + 1024 + h * 64 + vi];
            float sa = (s4[0] * a4[0] + s4[1] * a4[1]) + (s4[2] * a4[2] + s4[3] * a4[3]);
            sa = allreduce16(sa);
            s4 = s4 * w4 + (b4 * sa + k4 * v);
            float y = (s4[0] * r4[0] + s4[1] * r4[1]) + (s4[2] * r4[2] + s4[3] * r4[3]);
            y = allreduce16(y);
            if (kq == 0) YRAW[row * 512 + h * 64 + vi] = y;
        }
        *(f32x4*)(C.out + O_WKVS + ((size_t)seq * 64 + vi) * 64 + 4 * kq) = s4;
    }
}
__device__ __forceinline__ void phase_scan_post(const Ctx& C) {
    LANE_TID;
    const float* RKV = WSP(float, WS_RKV); const float* LO = WSP(float, WS_LO); const float* SI3 = WSP(float, WS_SI3); const float* YRAW = WSP(float, WS_YRAW);
    bf16* YAB = WSP(bf16, WS_YAB);
    const int c0 = LANE * 8, head = LANE >> 3, j0 = (LANE & 7) * 8;
    float lw[8], lb[8], rk[8];
#pragma unroll
    for (int e = 0; e < 8; ++e) { lw[e] = C.in[I_LNXW][c0 + e]; lb[e] = C.in[I_LNXB][c0 + e]; rk[e] = C.in[I_RK][c0 + e]; }
    for (int m = C.gw; m < M; m += C.ngw) {
        float y[8], r[8], kp[8], v[8], g[8];
        { const f32x4 t0 = *(const f32x4*)(YRAW + (size_t)m * 512 + c0), t1 = *(const f32x4*)(YRAW + (size_t)m * 512 + c0 + 4);
          const f32x4 r0 = *(const f32x4*)(RKV + (size_t)m * 1536 + c0), r1 = *(const f32x4*)(RKV + (size_t)m * 1536 + c0 + 4);
          const f32x4 v0 = *(const f32x4*)(RKV + (size_t)m * 1536 + 1024 + c0), v1 = *(const f32x4*)(RKV + (size_t)m * 1536 + 1024 + c0 + 4);
          const f32x4 g0 = *(const f32x4*)(LO + (size_t)m * 1536 + 1024 + c0), g1 = *(const f32x4*)(LO + (size_t)m * 1536 + 1024 + c0 + 4);
          const f32x4 k0 = *(const f32x4*)(SI3 + (size_t)m * 1536 + head * 192 + j0), k1 = *(const f32x4*)(SI3 + (size_t)m * 1536 + head * 192 + j0 + 4);
#pragma unroll
          for (int e = 0; e < 4; ++e) { y[e] = t0[e]; y[e + 4] = t1[e]; r[e] = r0[e]; r[e + 4] = r1[e]; v[e] = v0[e]; v[e + 4] = v1[e]; g[e] = g0[e]; g[e + 4] = g1[e]; kp[e] = k0[e]; kp[e + 4] = k1[e]; } }
        float s = 0.f, bo = 0.f;
#pragma unroll
        for (int e = 0; e < 8; ++e) { s += y[e]; bo += r[e] * kp[e] * rk[e]; }
        s += __shfl_xor(s, 1); s += __shfl_xor(s, 2); s += __shfl_xor(s, 4);
        bo += __shfl_xor(bo, 1); bo += __shfl_xor(bo, 2); bo += __shfl_xor(bo, 4);
        const float mean = s * (1.f / 64.f); float q = 0.f;
#pragma unroll
        for (int e = 0; e < 8; ++e) { const float d = y[e] - mean; q += d * d; }
        q += __shfl_xor(q, 1); q += __shfl_xor(q, 2); q += __shfl_xor(q, 4);
        const float rstd = rsqrtf(q * (1.f / 64.f) + GN_EPS);
        float o[8];
#pragma unroll
        for (int e = 0; e < 8; ++e) o[e] = ((y[e] - mean) * rstd * lw[e] + lb[e] + bo * v[e]) * g[e];
        u32x4 w; w.x = pk2(o[0], o[1]); w.y = pk2(o[2], o[3]); w.z = pk2(o[4], o[5]); w.w = pk2(o[6], o[7]);
        *(u32x4*)(YAB + (size_t)m * D + c0) = w;
    }
}
__device__ __forceinline__ void attn_prompt_unit(const bf16* Q, const bf16* KB, const bf16* VT, bf16* O, int b, int h, int qt, int wave, int lane) {
    const int fr = lane & 15, fq = lane >> 4;
    const size_t qrow = (size_t)b * SEQ + qt * 128 + wave * 16 + fr;
    bf16x8 qf[8];
#pragma unroll
    for (int s = 0; s < 8; ++s) qf[s] = *(const bf16x8*)(Q + qrow * D + h * 256 + s * 32 + fq * 8);
    f32x4 sc[16];
#pragma unroll
    for (int kt = 0; kt < 16; ++kt) {
        f32x4 acc = {0.f, 0.f, 0.f, 0.f};
        const bf16* kp = KB + ((size_t)b * NMEM + kt * 16 + fr) * D + h * 256 + fq * 8;
#pragma unroll
        for (int s = 0; s < 8; ++s) { const bf16x8 a = *(const bf16x8*)(kp + s * 32); acc = MFMA16(a, qf[s], acc); }
        sc[kt] = acc;
    }
    float mx = -3.0e38f;
#pragma unroll
    for (int kt = 0; kt < 16; ++kt) mx = fmaxf(fmaxf(mx, fmaxf(sc[kt][0], sc[kt][1])), fmaxf(sc[kt][2], sc[kt][3]));
    mx = fmaxf(mx, __shfl_xor(mx, 16)); mx = fmaxf(mx, __shfl_xor(mx, 32));
    float sum = 0.f;
#pragma unroll
    for (int kt = 0; kt < 16; ++kt)
#pragma unroll
        for (int j = 0; j < 4; ++j) { const float p = __builtin_amdgcn_exp2f(sc[kt][j] - mx); sc[kt][j] = p; sum += p; }
    sum += __shfl_xor(sum, 16); sum += __shfl_xor(sum, 32);
    const float inv = fast_rcp(sum);
    bf16x8 pf[8];
#pragma unroll
    for (int s = 0; s < 8; ++s) { u32x4 w; w.x = pk2(sc[2 * s][0], sc[2 * s][1]); w.y = pk2(sc[2 * s][2], sc[2 * s][3]); w.z = pk2(sc[2 * s + 1][0], sc[2 * s + 1][1]); w.w = pk2(sc[2 * s + 1][2], sc[2 * s + 1][3]);
        pf[s] = __builtin_bit_cast(bf16x8, w); }
#pragma unroll
    for (int dt = 0; dt < 16; ++dt) {
        f32x4 acc = {0.f, 0.f, 0.f, 0.f};
        const bf16* vp = VT + ((size_t)h * 256 + dt * 16 + fr) * MMEM + b * NMEM + fq * 4;
#pragma unroll
        for (int s = 0; s < 8; ++s) { const s16x4 lo = *(const s16x4*)(vp + 32 * s), hi = *(const s16x4*)(vp + 32 * s + 16);
            const bf16x8 a = __builtin_shufflevector(lo, hi, 0, 1, 2, 3, 4, 5, 6, 7); acc = MFMA16(a, pf[s], acc); }
        acc = acc * inv;
        u32x2 w; w.x = pk2(acc[0], acc[1]); w.y = pk2(acc[2], acc[3]);
        *(u32x2*)(O + qrow * D + h * 256 + dt * 16 + fq * 4) = w;
    }
}
__device__ __forceinline__ void attn_sample_unit(const Ctx& C, const bf16* Q, const float* CK, const float* CV, bf16* O, int b, int h) {
    LANE_TID;
    const int lane = LANE, wave = C.wave, fr = lane & 15, fq = lane >> 4;
    float* sS = (float*)C.lds;
    float* sP = sS + 1024;
    float* sO = sP + 1024;
    bf16x8 qf[8];
#pragma unroll
    for (int s = 0; s < 8; ++s) {
        s16x4 lo = {0, 0, 0, 0}, hi = {0, 0, 0, 0};
        if (fr < 4) { const bf16* qp = Q + ((size_t)MP + b * 4 + fr) * D + h * 256 + s * 32 + fq * 4; lo = *(const s16x4*)qp; hi = *(const s16x4*)(qp + 16); }
        qf[s] = __builtin_shufflevector(lo, hi, 0, 1, 2, 3, 4, 5, 6, 7);
    }
#pragma unroll
    for (int mt = 0; mt < 2; ++mt) {
        const int key = 32 * wave + 16 * mt + fr;
        const float* kp = CK + (((size_t)b * NMEM + key) * 4 + h) * 256 + fq * 4;
        f32x4 acc = {0.f, 0.f, 0.f, 0.f};
#pragma unroll
        for (int s = 0; s < 8; ++s) { const f32x4 x0 = *(const f32x4*)(kp + s * 32), x1 = *(const f32x4*)(kp + s * 32 + 16);
            u32x4 w; w.x = pk2(x0[0], x0[1]); w.y = pk2(x0[2], x0[3]); w.z = pk2(x1[0], x1[1]); w.w = pk2(x1[2], x1[3]);
            acc = MFMA16(__builtin_bit_cast(bf16x8, w), qf[s], acc); }
        if (fr < 4) {
#pragma unroll
            for (int j = 0; j < 4; ++j) sS[fr * 256 + 32 * wave + 16 * mt + 4 * fq + j] = acc[j];
        }
    }
    __syncthreads();
    if (wave < 4) {
        f32x4 v = *(const f32x4*)(sS + wave * 256 + lane * 4);
        const float mx = wave_max(fmaxf(fmaxf(v[0], v[1]), fmaxf(v[2], v[3])));
#pragma unroll
        for (int j = 0; j < 4; ++j) v[j] = __builtin_amdgcn_exp2f(v[j] - mx);
        const float inv = fast_rcp(wave_sum((v[0] + v[1]) + (v[2] + v[3])));
#pragma unroll
        for (int j = 0; j < 4; ++j) sP[(lane * 4 + j) * 4 + wave] = v[j] * inv;
    }
    __syncthreads();
    f32x4 o0 = {0.f, 0.f, 0.f, 0.f}, o1 = o0, o2 = o0, o3 = o0;
    const float* vp = CV + (((size_t)b * NMEM + 32 * wave) * 4 + h) * 256 + 4 * lane;
#pragma unroll 8
    for (int kk = 0; kk < 32; ++kk) {
        const f32x4 v = *(const f32x4*)(vp + (size_t)kk * 1024); const f32x4 p = *(const f32x4*)(sP + (32 * wave + kk) * 4);
        o0 += v * p[0]; o1 += v * p[1]; o2 += v * p[2]; o3 += v * p[3];
    }
    *(f32x4*)(sO + (wave * 4 + 0) * 256 + 4 * lane) = o0; *(f32x4*)(sO + (wave * 4 + 1) * 256 + 4 * lane) = o1;
    *(f32x4*)(sO + (wave * 4 + 2) * 256 + 4 * lane) = o2; *(f32x4*)(sO + (wave * 4 + 3) * 256 + 4 * lane) = o3;
    __syncthreads();
    { const int idx = TID * 2, q = idx >> 8, d = idx & 255; float a0 = 0.f, a1 = 0.f;
#pragma unroll
      for (int w = 0; w < 8; ++w) { const f32x2 t = *(const f32x2*)(sO + (w * 4 + q) * 256 + d); a0 += t[0]; a1 += t[1]; }
      *(unsigned*)(O + ((size_t)MP + b * 4 + q) * D + h * 256 + d) = pk2(a0, a1); }
    __syncthreads();
}
__device__ __forceinline__ void phase_attn(const Ctx& C, int l) {
    LANE_TID;
    const bf16* Q = WSP(bf16, WS_Q); bf16* O = WSP(bf16, WS_O);
    const bf16* KB = WSP(bf16, WS_KB) + (size_t)l * MMEM * D; const bf16* VT = WSP(bf16, WS_VT) + (size_t)l * D * MMEM;
    for (int u = C.bid; u < BATCH * 4 * 16; u += C.G) { const int qt = u & 15, h = (u >> 4) & 3, b = u >> 6; attn_prompt_unit(Q, KB, VT, O, b, h, qt, C.wave, LANE); }
    const float* CK = C.in[I_CK] + (size_t)l * DEC_B * NMEM * D; const float* CV = C.in[I_CV] + (size_t)l * DEC_B * NMEM * D;
    for (int u = C.bid; u < DEC_B * 4; u += C.G) attn_sample_unit(C, Q, CK, CV, O, u >> 2, u & 3);
}
__device__ __forceinline__ void phase_gmlp(const Ctx& C) {
    LANE_TID;
    const float* ZG = WSP(float, WS_P); bf16* YC = WSP(bf16, WS_YAB); const float* vs = SSA(9); const float* vq = SSA(10);
    const float* lnw = C.in[I_GLNW]; const float* lnb = C.in[I_GLNB]; const float* ws = C.in[I_GWS]; const float* bs = C.in[I_GBS];
    constexpr int LP = 136;
    bf16* Wl = (bf16*)C.lds; bf16* Vl = Wl + 128 * LP;
    const int fr = LANE & 15, fq = LANE >> 4;
    for (int u = C.bid; u < BATCH * 16 * 8; u += C.G) {
        const int g = u & 7, n = (u >> 3) & 15, b = u >> 7; const size_t row0 = (size_t)b * SEQ + n * 128;
        __syncthreads();
#pragma unroll
        for (int j = 0; j < 8; ++j) {
            const int e = TID + NTHR * j, t = e >> 5, s4 = (e & 31) * 4;
            f32x4 w = *(const f32x4*)(ws + ((size_t)g * 128 + t) * 128 + s4);
#pragma unroll
            for (int i = 0; i < 4; ++i) if (s4 + i > t) w[i] = 0.f;
            u32x2 o; o.x = pk2(w[0], w[1]); o.y = pk2(w[2], w[3]); *(u32x2*)(Wl + t * LP + s4) = o;
            const int s = t, c4 = s4;
            const f32x4 v = *(const f32x4*)(ZG + (row0 + s) * 2048 + 1024 + g * 128 + c4);
            const float mean = vs[row0 + s] * (1.f / 1024.f); const float rstd = rsqrtf(fmaxf(vq[row0 + s] * (1.f / 1024.f) - mean * mean, 0.f) + LN_EPS);
            const f32x4 lw = *(const f32x4*)(lnw + g * 128 + c4), lb = *(const f32x4*)(lnb + g * 128 + c4);
#pragma unroll
            for (int i = 0; i < 4; ++i) Vl[(c4 + i) * LP + s] = (bf16)(pk2((v[i] - mean) * rstd * lw[i] + lb[i], 0.f) & 0xffffu);
        }
        __syncthreads();
        const int t = 16 * C.wave + fr; const float bt = bs[g * 128 + t];
        bf16x8 bfr[4];
#pragma unroll
        for (int ks = 0; ks < 4; ++ks) bfr[ks] = *(const bf16x8*)(Wl + t * LP + ks * 32 + fq * 8);
#pragma unroll
        for (int ct = 0; ct < 8; ++ct) {
            f32x4 acc = {0.f, 0.f, 0.f, 0.f};
#pragma unroll
            for (int ks = 0; ks < 4; ++ks) { const bf16x8 a = *(const bf16x8*)(Vl + (ct * 16 + fr) * LP + ks * 32 + fq * 8); acc = MFMA16(a, bfr[ks], acc); }
            const f32x4 uu = *(const f32x4*)(ZG + (row0 + t) * 2048 + g * 128 + ct * 16 + fq * 4);
            const f32x4 y = uu * (acc + bt);
            u32x2 o; o.x = pk2(y[0], y[1]); o.y = pk2(y[2], y[3]); *(u32x2*)(YC + (row0 + t) * D + g * 128 + ct * 16 + fq * 4) = o;
        }
    }
    for (int b = C.gw; b < DEC_B; b += C.ngw) {
        const size_t row0 = (size_t)MP + b * 4;
        f32x4 vn[4][4];
#pragma unroll
        for (int s = 0; s < 4; ++s) {
            const float mean = vs[row0 + s] * (1.f / 1024.f); const float rstd = rsqrtf(fmaxf(vq[row0 + s] * (1.f / 1024.f) - mean * mean, 0.f) + LN_EPS);
#pragma unroll
            for (int j = 0; j < 4; ++j) { const int c = (64 * j + LANE) * 4;
                const f32x4 v = *(const f32x4*)(ZG + (row0 + s) * 2048 + 1024 + c); const f32x4 lw = *(const f32x4*)(lnw + c), lb = *(const f32x4*)(lnb + c);
                vn[s][j] = (v - mean) * rstd * lw + lb;
                *(f32x4*)(C.out + O_GVS + ((size_t)b * 4 + s) * D + c) = vn[s][j]; }
        }
#pragma unroll
        for (int t = 0; t < 4; ++t)
#pragma unroll
            for (int j = 0; j < 4; ++j) { const int c = (64 * j + LANE) * 4, g = c >> 7;
                f32x4 f = {0.f, 0.f, 0.f, 0.f}; f += bs[g * 128 + t];
#pragma unroll
                for (int s = 0; s <= t; ++s) f += vn[s][j] * ws[((size_t)g * 128 + t) * 128 + s];
                const f32x4 uu = *(const f32x4*)(ZG + (row0 + t) * 2048 + c); const f32x4 y = uu * f;
                u32x2 o; o.x = pk2(y[0], y[1]); o.y = pk2(y[2], y[3]); *(u32x2*)(YC + (row0 + t) * D + c) = o; }
    }
}
__device__ __forceinline__ void phase_final(const Ctx& C) {
    LANE_TID;
    const float* X = WSP(float, WS_X); const float* ss = SSA(8); const float* fw = C.in[I_FNORM];
    f32x4 w[4];
#pragma unroll
    for (int j = 0; j < 4; ++j) w[j] = ((const f32x4*)fw)[64 * j + LANE];
    for (int m = C.gw; m < M; m += C.ngw) {
        const float r = rsqrtf(ss[m] * (1.f / 1024.f) + RMS_EPS);
#pragma unroll
        for (int j = 0; j < 4; ++j) ((f32x4*)(C.out + (size_t)m * D))[64 * j + LANE] = ((const f32x4*)(X + (size_t)m * D))[64 * j + LANE] * r * w[j];
    }
}

#define GEMM_RUN(EPI, Aptr, Bptr, MM, NN, KK, coff, ...) do { pg8::Gemm g_{(const pg8::bf16_t*)(Aptr), (const pg8::bf16_t*)(Bptr), (MM), (NN), (KK)}; pg8::StaticOrder S_; \
    S_.init((MM), (NN), C.G, (C.bid + C.G - ((coff) % C.G)) % C.G); EPI E_{__VA_ARGS__}; \
    pg8::gemm_phase<EPI, pg8::StaticOrder, true, true>((LAS unsigned char*)C.lds, g_, S_, E_, C.wave); } while (0)

constexpr int N_PHASES = 26;
#ifndef PHMASK
#define PHMASK 0xFFFFFFFFu
#endif
#define IN(k) (((PHMASK >> (k)) & 1u) && lo <= (k) && (k) < hi)
__device__ __forceinline__ void grid_bar(unsigned* cnt, unsigned target, int wave) {
    asm volatile("s_waitcnt vmcnt(0)" ::: "memory");
    __syncthreads();
    if (wave == 0) {
        if (lane_id_fresh() == 0) {
            __builtin_amdgcn_fence(__ATOMIC_RELEASE, "agent");
            asm volatile("s_waitcnt vmcnt(0)" ::: "memory");
            __hip_atomic_fetch_add(cnt, 1u, __ATOMIC_RELAXED, __HIP_MEMORY_SCOPE_AGENT);
            while (__hip_atomic_load(cnt, __ATOMIC_RELAXED, __HIP_MEMORY_SCOPE_AGENT) < target) __builtin_amdgcn_s_sleep(2);
        }
        __builtin_amdgcn_fence(__ATOMIC_ACQUIRE, "agent");
        asm volatile("s_waitcnt vmcnt(0)" ::: "memory");
    }
    __syncthreads();
}
#define SEAM(k) do { if (lo <= (k) && (k) + 1 < hi) { if ((k) == 0) cg::this_grid().sync(); else grid_bar(WSP(unsigned, WS_BAR), (unsigned)(k) * (unsigned)C.G, C.wave); } } while (0)
template <int L> __device__ __forceinline__ void layer_phases(const Ctx& C, const int lo, const int hi) {
    constexpr int P0 = L == 0 ? 1 : 15;
    constexpr int P_UP1 = P0, P_DN1 = P0 + 1, P_WIN = P0 + 2, P_WOUT = L == 0 ? P0 + 8 : P0 + 4, P_WQ = P_WOUT + 1, P_ATT = P_WOUT + 2, P_WO = P_WOUT + 3, P_UP2 = P_WOUT + 4, P_DN2 = P_WOUT + 5;
    float* X = WSP(float, WS_X); bf16* XB = WSP(bf16, WS_XB); bf16* HB = WSP(bf16, WS_HB);
    const bf16* wup1 = WSP(bf16, WS_WUP) + (size_t)(L * 2 + 0) * (2 * FF * D); const bf16* wup2 = WSP(bf16, WS_WUP) + (size_t)(L * 2 + 1) * (2 * FF * D);
    const bf16* wdn1 = WSP(bf16, WS_WDN) + (size_t)(L * 2 + 0) * (D * FF);     const bf16* wdn2 = WSP(bf16, WS_WDN) + (size_t)(L * 2 + 1) * (D * FF);
    if (IN(P_UP1)) {
        GEMM_RUN(pg8::EpiSwiGLU, XB, wup1, M, 2 * FF, D, 0, HB, SSA(4 * L + 0));
        if (L == 0) {
            GEMM_RUN(pg8::EpiBf16, WSP(bf16, WS_WKV) + (size_t)1 * D * D, WSP(bf16, WS_MEMB), D, MMEM, D, (66 * 22), WSP(bf16, WS_VT), MMEM, nullptr, 1.f);
            GEMM_RUN(pg8::EpiBf16, WSP(bf16, WS_WKV) + (size_t)3 * D * D, WSP(bf16, WS_MEMB), D, MMEM, D, (66 * 22 + 32), WSP(bf16, WS_VT) + (size_t)D * MMEM, MMEM, nullptr, 1.f);
        }
    }
    SEAM(P_UP1);
    if (IN(P_DN1)) GEMM_RUN(pg8::EpiResid, HB, wdn1, M, D, FF, 0, X, XB, SSA(4 * L + 1), 0.5f);
    SEAM(P_DN1);
    if (L == 0) {
        if (IN(P_WIN)) {
            GEMM_RUN(pg8::EpiF32<0>, XB, WSP(bf16, WS_WINE), M, PINE, D, 0, WSP(float, WS_P), PINE, SSA(1), nullptr, nullptr);
            GEMM_RUN(pg8::EpiKV, WSP(bf16, WS_MEMB), WSP(bf16, WS_WKV), MMEM, 4 * D, D, (66 * 13), C.out + O_MKP, C.out + O_MVP, WSP(bf16, WS_KB));
        }
        SEAM(P_WIN);
        if (IN(P_WIN + 1)) phase_shift_conv(C);
        SEAM(P_WIN + 1);
        if (IN(P_WIN + 2)) GEMM_RUN(pg8::EpiLoRA, WSP(bf16, WS_AL), WSP(bf16, WS_LW), M, NLORA, KLORA, 0, WSP(float, WS_LO), WSP(float, WS_LB));
        SEAM(P_WIN + 2);
        if (IN(P_WIN + 3)) phase_scan_prep(C);
        SEAM(P_WIN + 3);
        if (IN(P_WIN + 4)) phase_scan(C);
        SEAM(P_WIN + 4);
        if (IN(P_WIN + 5)) phase_scan_post(C);
        SEAM(P_WIN + 5);
    } else {
        if (IN(P_WIN)) GEMM_RUN(pg8::EpiF32<1>, XB, WSP(bf16, WS_WINO), M, 2 * D, D, 0, WSP(float, WS_P), 2 * D, SSA(5), SSA(9), SSA(10));
        SEAM(P_WIN);
        if (IN(P_WIN + 1)) phase_gmlp(C);
        SEAM(P_WIN + 1);
    }
    if (IN(P_WOUT)) GEMM_RUN(pg8::EpiResid, WSP(bf16, WS_YAB), L == 0 ? WSP(bf16, WS_WOUTE) : WSP(bf16, WS_WOUTO), M, D, D, 0, X, XB, SSA(4 * L + 2), 1.0f);
    SEAM(P_WOUT);
    if (IN(P_WQ)) GEMM_RUN(pg8::EpiBf16, XB, WSP(bf16, WS_WQ) + (size_t)L * D * D, M, D, D, 0, WSP(bf16, WS_Q), D, SSA(4 * L + 2), QSCALE);
    SEAM(P_WQ);
    if (IN(P_ATT)) phase_attn(C, L);
    SEAM(P_ATT);
    if (IN(P_WO)) GEMM_RUN(pg8::EpiResid, WSP(bf16, WS_O), WSP(bf16, WS_WO) + (size_t)L * D * D, M, D, D, 0, X, XB, SSA(4 * L + 3), 1.0f);
    SEAM(P_WO);
    if (IN(P_UP2)) GEMM_RUN(pg8::EpiSwiGLU, XB, wup2, M, 2 * FF, D, 0, HB, SSA(4 * L + 3));
    SEAM(P_UP2);
    if (IN(P_DN2)) GEMM_RUN(pg8::EpiResid, HB, wdn2, M, D, FF, 0, X, XB, SSA(4 * L + 4), 0.5f);
    SEAM(P_DN2);
}
__global__ void __launch_bounds__(NTHR, 2) mega_fwd(Args args) {
    extern __shared__ __attribute__((aligned(16))) unsigned char lds[];
    Ctx C; C.lds = lds; C.wave = __builtin_amdgcn_readfirstlane((int)threadIdx.x >> 6); C.G = gridDim.x; C.bid = blockIdx.x;
    C.gw = C.bid * NWAVES + C.wave; C.ngw = C.G * NWAVES; C.in = args.in; C.out = args.out; C.ws = args.ws;
    const int lo = args.ph_lo, hi = args.ph_hi;
    if (IN(0)) phase_prologue(C);
    SEAM(0);
    layer_phases<0>(C, lo, hi);
    layer_phases<1>(C, lo, hi);
    if (IN(25)) phase_final(C);
}

#ifndef MK_PER_PHASE
#define MK_PER_PHASE 1
#endif
extern "C" void kernel_launch(void* const* d_in, const int* in_sizes, int n_in, void* d_out, int out_size, void* d_ws, size_t ws_size, hipStream_t stream) {
    static int grid = 0;
    if (grid == 0) {
        if (n_in != N_IN || (size_t)out_size != O_END || ws_size < WS_END) { fprintf(stderr, "kernel_launch: unexpected shapes n_in %d out %d ws %zu (need %zu)\n", n_in, out_size, ws_size, (size_t)WS_END); grid = -1; return; }
        int dev = 0, cus = 0, per_cu = 0;
        (void)hipGetDevice(&dev); (void)hipDeviceGetAttribute(&cus, hipDeviceAttributeMultiprocessorCount, dev);
        if (hipFuncSetAttribute((const void*)mega_fwd, hipFuncAttributeMaxDynamicSharedMemorySize, LDS_BYTES) != hipSuccess) { fprintf(stderr, "kernel_launch: hipFuncSetAttribute failed\n"); grid = -1; return; }
        if (hipOccupancyMaxActiveBlocksPerMultiprocessor(&per_cu, (const void*)mega_fwd, NTHR, LDS_BYTES) != hipSuccess || per_cu < 1) { fprintf(stderr, "kernel_launch: occupancy query failed (%d)\n", per_cu); per_cu = 1; }
        (void)hipGetLastError();
        grid = cus * per_cu;
    }
    if (grid < 0) return;
    Args a{};
    for (int i = 0; i < N_IN; ++i) a.in[i] = (const float*)d_in[i];
    a.out = (float*)d_out; a.ws = (unsigned char*)d_ws;
#if MK_PER_PHASE
    for (int p = 0; p < N_PHASES; ++p) { a.ph_lo = p; a.ph_hi = p + 1; hipLaunchKernelGGL(mega_fwd, dim3(grid), dim3(NTHR), LDS_BYTES, stream, a); }
#else
    a.ph_lo = 0; a.ph_hi = N_PHASES;
    void* kargs[] = {&a};
    hipError_t e = hipLaunchCooperativeKernel((const void*)mega_fwd, dim3(grid), dim3(NTHR), kargs, LDS_BYTES, stream);
    if (e != hipSuccess) fprintf(stderr, "kernel_launch: cooperative launch failed: %s (grid %d)\n", hipGetErrorString(e), grid);
#endif
}
```
